# Optimizing an MI355X kernel written in HIP

```python
import math
import jax, jax.numpy as jnp
from jax import lax
import numpy as np

D_MODEL = 1024
BATCH = 8
SEQ = 8192
DEPTH = 1

HEAD_DIM = 64
N_ATTN_HEADS = 8
N_KV_HEADS = 2
N_GMLP_GROUPS = 8
GMLP_GROUP_DIM = 64
ATTN_WIDTH = N_ATTN_HEADS * HEAD_DIM
KV_WIDTH = N_KV_HEADS * HEAD_DIM
GMLP_WIDTH = N_GMLP_GROUPS * GMLP_GROUP_DIM
MIX_WIDTH = ATTN_WIDTH + GMLP_WIDTH
IN_WIDTH = ATTN_WIDTH + 2 * KV_WIDTH + 2 * GMLP_WIDTH
WINDOW = 128
BLOCK = 128
CHUNK = 128
N_BUCKETS = 32
MAX_DISTANCE = 128
D_FF = -(-8 * D_MODEL // (3 * 256)) * 256
ALPHA = (2 * DEPTH) ** 0.25
BETA = (8 * DEPTH) ** -0.25
LN_EPS = 1e-5
NEG_INF = -1e30

kernel_name = "hymba_gmlp_swa_sink_deepnorm_adaln"


def layer_norm(x, g, b):
    xf = x.astype(jnp.float32)
    mu = jnp.mean(xf, axis=-1, keepdims=True)
    var = jnp.mean(jnp.square(xf - mu), axis=-1, keepdims=True)
    return ((xf - mu) * lax.rsqrt(var + LN_EPS) * g.astype(jnp.float32) + b.astype(jnp.float32)).astype(x.dtype)


def rms_norm(x, g):
    xf = x.astype(jnp.float32)
    ms = jnp.mean(jnp.square(xf), axis=-1, keepdims=True)
    return (xf * lax.rsqrt(ms + LN_EPS) * g.astype(jnp.float32)).astype(x.dtype)


def t5_bucket(dist):
    max_exact = N_BUCKETS // 2
    n = jnp.maximum(dist, 0)
    nf = jnp.maximum(n, max_exact).astype(jnp.float32)
    large = max_exact + (jnp.log(nf / max_exact) / math.log(MAX_DISTANCE / max_exact)
                         * (N_BUCKETS - max_exact)).astype(jnp.int32)
    large = jnp.minimum(large, N_BUCKETS - 1)
    return jnp.where(n < max_exact, n, large)


def sliding_window_attention(q, k, v, sinks, rel_bias):
    B, S, H, Dh = q.shape
    nb = S // BLOCK
    G = H // N_KV_HEADS
    qb = q.reshape(B, nb, BLOCK, N_KV_HEADS, G, Dh)
    kb = k.reshape(B, nb, BLOCK, N_KV_HEADS, Dh)
    vb = v.reshape(B, nb, BLOCK, N_KV_HEADS, Dh)
    kpad = jnp.zeros_like(kb[:, :1])
    vpad = jnp.zeros_like(vb[:, :1])
    kk = jnp.concatenate([jnp.concatenate([kpad, kb[:, :-1]], axis=1), kb], axis=2)
    vv = jnp.concatenate([jnp.concatenate([vpad, vb[:, :-1]], axis=1), vb], axis=2)
    logits = jnp.einsum('bnqkgd,bnskd->bnkgqs', qb, kk,
                        preferred_element_type=jnp.float32) * (Dh ** -0.5)
    qi = jnp.arange(BLOCK)[:, None]
    si = jnp.arange(2 * BLOCK)[None, :]
    dist = qi + BLOCK - si
    in_window = (dist >= 0) & (dist < WINDOW)
    bias = rel_bias.astype(jnp.float32)[t5_bucket(dist)]
    bias = bias.transpose(2, 0, 1).reshape(N_KV_HEADS, G, BLOCK, 2 * BLOCK)
    valid = in_window[None] & ((jnp.arange(nb)[:, None, None] > 0) | (si[None] >= BLOCK))
    logits = jnp.where(valid[None, :, None, None], logits + bias[None, None], NEG_INF)
    sink = sinks.astype(jnp.float32).reshape(N_KV_HEADS, G)[None, None, :, :, None, None]
    m = jnp.maximum(jnp.max(logits, axis=-1, keepdims=True), sink)
    p = jnp.exp(logits - m)
    p = p / (jnp.sum(p, axis=-1, keepdims=True) + jnp.exp(sink - m))
    out = jnp.einsum('bnkgqs,bnskd->bnqkgd', p.astype(v.dtype), vv)
    return out.reshape(B, S, H * Dh)


def chunked_spatial_gating(u, v, ln_g, ln_b, w_s, b_s):
    B, S, _ = u.shape
    nc = S // CHUNK
    G, Dg = N_GMLP_GROUPS, GMLP_GROUP_DIM
    u = jax.nn.gelu(u).reshape(B, nc, CHUNK, G, Dg)
    v = layer_norm(jax.nn.gelu(v).reshape(B, S, G, Dg), ln_g.reshape(G, Dg), ln_b.reshape(G, Dg))
    v = v.reshape(B, nc, CHUNK, G, Dg)
    causal = jnp.tril(jnp.ones((CHUNK, CHUNK), dtype=bool))
    w = jnp.where(causal[None], w_s, jnp.zeros_like(w_s))
    mixed = jnp.einsum('gts,bnsgc->bntgc', w, v) + b_s.T[None, None, :, :, None]
    return (u * mixed).reshape(B, S, GMLP_WIDTH)


def _normal(key, shape, scale):
    return jax.random.normal(key, shape, dtype=jnp.float32) * scale


def setup_inputs(seed: int = 0) -> dict:
    key = jax.random.key(seed)
    ks = jax.random.split(key, 24)
    L = DEPTH
    w_in = _normal(ks[5], (L, D_MODEL, IN_WIDTH), D_MODEL ** -0.5)
    v_lo, v_hi = ATTN_WIDTH + KV_WIDTH, ATTN_WIDTH + 2 * KV_WIDTH
    w_in = w_in.at[:, :, v_lo:v_hi].multiply(BETA)
    return {
        "x": _normal(ks[0], (BATCH, SEQ, D_MODEL), 1.0),
        "c": _normal(ks[1], (BATCH, D_MODEL), 1.0),
        "rel_bias": _normal(ks[2], (N_BUCKETS, N_ATTN_HEADS), 0.5),
        "w_ada": _normal(ks[3], (L, D_MODEL, 6 * D_MODEL), 0.5 * D_MODEL ** -0.5),
        "b_ada": _normal(ks[4], (L, 6 * D_MODEL), 0.01),
        "w_in": w_in,
        "b_in": _normal(ks[6], (L, IN_WIDTH), 0.01),
        "attn_sinks": _normal(ks[7], (L, N_ATTN_HEADS), 0.5),
        "gmlp_ln_g": 1.0 + _normal(ks[8], (L, GMLP_WIDTH), 0.01),
        "gmlp_ln_b": _normal(ks[9], (L, GMLP_WIDTH), 0.01),
        "gmlp_w_s": _normal(ks[10], (L, N_GMLP_GROUPS, CHUNK, CHUNK), CHUNK ** -0.5),
        "gmlp_b_s": 1.0 + _normal(ks[11], (L, N_GMLP_GROUPS, CHUNK), 0.01),
        "attn_out_g": 1.0 + _normal(ks[12], (L, ATTN_WIDTH), 0.01),
        "gmlp_out_g": 1.0 + _normal(ks[13], (L, GMLP_WIDTH), 0.01),
        "w_out": _normal(ks[14], (L, MIX_WIDTH, D_MODEL), BETA * MIX_WIDTH ** -0.5),
        "ln1_g": 1.0 + _normal(ks[15], (L, D_MODEL), 0.01),
        "ln1_b": _normal(ks[16], (L, D_MODEL), 0.01),
        "w_gate_up": _normal(ks[17], (L, D_MODEL, 2 * D_FF), D_MODEL ** -0.5),
        "w_down": _normal(ks[18], (L, D_FF, D_MODEL), BETA * D_FF ** -0.5),
        "ln2_g": 1.0 + _normal(ks[19], (L, D_MODEL), 0.01),
        "ln2_b": _normal(ks[20], (L, D_MODEL), 0.01),
    }


def reference(x, c, rel_bias, w_ada, b_ada, w_in, b_in, attn_sinks, gmlp_ln_g, gmlp_ln_b,
              gmlp_w_s, gmlp_b_s, attn_out_g, gmlp_out_g, w_out, ln1_g, ln1_b,
              w_gate_up, w_down, ln2_g, ln2_b):
    B, S, _ = x.shape
    splits = [ATTN_WIDTH, ATTN_WIDTH + KV_WIDTH, ATTN_WIDTH + 2 * KV_WIDTH,
              ATTN_WIDTH + 2 * KV_WIDTH + GMLP_WIDTH]
    for layer in range(DEPTH):
        mod = jax.nn.silu(c) @ w_ada[layer] + b_ada[layer]
        sh1, sc1, g1, sh2, sc2, g2 = jnp.split(mod[:, None, :], 6, axis=-1)

        h = x * (1.0 + sc1) + sh1
        proj = h @ w_in[layer] + b_in[layer]
        q, k, v, gu, gv = jnp.split(proj, splits, axis=-1)
        attn = sliding_window_attention(
            q.reshape(B, S, N_ATTN_HEADS, HEAD_DIM),
            k.reshape(B, S, N_KV_HEADS, HEAD_DIM),
            v.reshape(B, S, N_KV_HEADS, HEAD_DIM),
            attn_sinks[layer], rel_bias)
        gm = chunked_spatial_gating(gu, gv, gmlp_ln_g[layer], gmlp_ln_b[layer],
                                    gmlp_w_s[layer], gmlp_b_s[layer])
        mixed = jnp.concatenate([rms_norm(attn, attn_out_g[layer]),
                                 rms_norm(gm, gmlp_out_g[layer])], axis=-1)
        y = mixed @ w_out[layer]
        x = layer_norm(ALPHA * x + g1 * y, ln1_g[layer], ln1_b[layer])

        h = x * (1.0 + sc2) + sh2
        gate, up = jnp.split(h @ w_gate_up[layer], 2, axis=-1)
        y = (jax.nn.silu(gate) * up) @ w_down[layer]
        x = layer_norm(ALPHA * x + g2 * y, ln2_g[layer], ln2_b[layer])
    return x
```

```cpp
#include <hip/hip_runtime.h>
#include <cstdio>
#include <cstdint>
constexpr int BATCH = 8, SEQ = 8192, DM = 1024, MROWS = BATCH * SEQ;
constexpr int NIN = 1792, DFF = 2816, NMOD = 6144;
constexpr int PC_Q = 0, PC_K = 512, PC_V = 640, PC_GU = 768, PC_GV = 1280;
constexpr float QSCALE = 0.125f * 1.4426950408889634f;
constexpr float LOG2E = 1.4426950408889634f;
constexpr float ALPHA_F = 1.189207115002721f;
constexpr float LN_EPS = 1e-5f;
constexpr size_t MiB = 1u << 20;
constexpr size_t WS_CTL = 0, CTL_ZERO_BYTES = 1 * MiB;
constexpr size_t WS_MOD = 1 * MiB;
constexpr size_t WS_MODP = 1 * MiB + 256 * 1024;
constexpr size_t WS_WIN = 2 * MiB, WS_WOUT = 6 * MiB, WS_WGU = 8 * MiB, WS_WD = 19 * MiB, WS_WS = 25 * MiB;
constexpr size_t WS_X = 26 * MiB;
constexpr size_t WS_PROJ = 32 * MiB;
constexpr size_t WS_MIXED = 256 * MiB;
constexpr size_t WS_H = 384 * MiB;
constexpr size_t WS_HID = 512 * MiB;
constexpr size_t WS_END = 1024 * MiB;
constexpr size_t WS_SCR = 512 * MiB;
constexpr size_t WS_Y2 = 256 * MiB;

namespace nv {
typedef unsigned short bf16;
__device__ __forceinline__ float bf2f(bf16 v) { return __uint_as_float(((unsigned)v) << 16); }
__device__ __forceinline__ bf16 f2bf(float f) { unsigned u = __float_as_uint(f); return (bf16)((u + 0x7fffu + ((u >> 16) & 1u)) >> 16); }
__device__ __forceinline__ float gelu_tanh(float x) { const float u = 0.7978845608028654f * (x + 0.044715f * x * x * x); return 0.5f * x * (1.0f + tanhf(u)); }
__device__ __forceinline__ float silu(float x) { return x / (1.0f + __expf(-x)); }
__device__ __forceinline__ float wave_sum(float v) {
#pragma unroll
    for (int o = 1; o < 64; o <<= 1) v += __shfl_xor(v, o);
    return v; }
__device__ __forceinline__ float wave_max(float v) {
#pragma unroll
    for (int o = 1; o < 64; o <<= 1) v = fmaxf(v, __shfl_xor(v, o));
    return v; }

__global__ void __launch_bounds__(256) k_mod(const float* c, const float* w_ada, const float* b_ada, float* mod) {
    __shared__ float sc[8 * 1024];
    for (int i = threadIdx.x; i < 8 * 1024; i += 256) sc[i] = silu(c[i]);
    __syncthreads();
    const int n = blockIdx.x * 256 + threadIdx.x;
    float acc[8];
#pragma unroll
    for (int b = 0; b < 8; ++b) acc[b] = 0.f;
    for (int k = 0; k < 1024; ++k) { const float w = w_ada[(size_t)k * 6144 + n];
#pragma unroll
        for (int b = 0; b < 8; ++b) acc[b] += sc[b * 1024 + k] * w; }
#pragma unroll
    for (int b = 0; b < 8; ++b) mod[b * 6144 + n] = acc[b] + b_ada[n];
}

struct AModX { const float* x; const float* mod;
    __device__ __forceinline__ float operator()(int row, int k) const { const int b = row >> 13; return x[(size_t)row * 1024 + k] * (1.0f + mod[b * 6144 + 1024 + k]) + mod[b * 6144 + k]; } };
struct ABf16 { const bf16* A; int lda; int pad;
    __device__ __forceinline__ float operator()(int row, int k) const { return bf2f(A[(size_t)row * lda + k]); } };
struct ColId { __device__ __forceinline__ int operator()(int n0, int n) const { return n0 + n; } };
struct ColGU { __device__ __forceinline__ int operator()(int n0, int n) const { const int hb = (n0 >> 7) * 64; return n < 64 ? hb + n : 2816 + hb + (n - 64); } };
struct EpiF32 { float* C; int ldc; int pad;
    __device__ __forceinline__ void operator()(float (&acc)[8][8], int m0, int n0, int ty, int tx) const {
#pragma unroll
        for (int i = 0; i < 8; ++i) { const int row = m0 + (i >> 2) * 64 + ty * 4 + (i & 3);
#pragma unroll
            for (int j = 0; j < 8; ++j) { const int col = n0 + (j >> 2) * 64 + tx * 4 + (j & 3); C[(size_t)row * ldc + col] = acc[i][j]; } } } };
struct EpiSwiGLU { bf16* H;
    __device__ __forceinline__ void operator()(float (&acc)[8][8], int m0, int n0, int ty, int tx) const { const int hb = (n0 >> 7) * 64;
#pragma unroll
        for (int i = 0; i < 8; ++i) { const int row = m0 + (i >> 2) * 64 + ty * 4 + (i & 3);
#pragma unroll
            for (int j = 0; j < 4; ++j) { const float g = acc[i][j], u = acc[i][4 + j]; H[(size_t)row * 2816 + hb + tx * 4 + j] = f2bf(silu(g) * u); } } } };

template <class AF, class CF, class EF>
__global__ void __launch_bounds__(256) k_gemm(AF af, const float* W, EF ef, int ldw, int K) {
    const CF cf{};
    __shared__ float As[8][128 + 4];
    __shared__ float Bs[8][128 + 4];
    const int tid = threadIdx.x, tx = tid & 15, ty = tid >> 4;
    const int m0 = blockIdx.y * 128, n0 = blockIdx.x * 128;
    float acc[8][8];
#pragma unroll
    for (int i = 0; i < 8; ++i)
#pragma unroll
        for (int j = 0; j < 8; ++j) acc[i][j] = 0.f;
    for (int k0 = 0; k0 < K; k0 += 8) {
#pragma unroll
        for (int i = 0; i < 4; ++i) { const int e = tid + i * 256; const int m = e >> 3, k = e & 7; As[k][m] = af(m0 + m, k0 + k); }
#pragma unroll
        for (int i = 0; i < 4; ++i) { const int e = tid + i * 256; const int k = e >> 7, n = e & 127; Bs[k][n] = W[(size_t)(k0 + k) * ldw + cf(n0, n)]; }
        __syncthreads();
#pragma unroll
        for (int kk = 0; kk < 8; ++kk) {
            float a[8], b[8];
#pragma unroll
            for (int i = 0; i < 8; ++i) a[i] = As[kk][(i >> 2) * 64 + ty * 4 + (i & 3)];
#pragma unroll
            for (int j = 0; j < 8; ++j) b[j] = Bs[kk][(j >> 2) * 64 + tx * 4 + (j & 3)];
#pragma unroll
            for (int i = 0; i < 8; ++i)
#pragma unroll
                for (int j = 0; j < 8; ++j) acc[i][j] += a[i] * b[j];
        }
        __syncthreads();
    }
    ef(acc, m0, n0, ty, tx);
}

__global__ void __launch_bounds__(256) k_proj_epi(const float* scr, const float* b_in, const float* ln_g, const float* ln_b, bf16* proj, float qscale, int pad) {
    const int row = blockIdx.x * 4 + (threadIdx.x >> 6), lane = threadIdx.x & 63;
    const float* s = scr + (size_t)row * 1792; bf16* o = proj + (size_t)row * 1792;
    for (int c = lane; c < 512; c += 64) o[c] = f2bf((s[c] + b_in[c]) * qscale);
    for (int c = 512 + lane; c < 768; c += 64) o[c] = f2bf(s[c] + b_in[c]);
    for (int c = 768 + lane; c < 1280; c += 64) o[c] = f2bf(gelu_tanh(s[c] + b_in[c]));
    for (int g = 0; g < 8; ++g) { const int c = 1280 + g * 64 + lane; const float v = gelu_tanh(s[c] + b_in[c]);
        const float mu = wave_sum(v) * (1.f / 64.f); const float d = v - mu; const float var = wave_sum(d * d) * (1.f / 64.f);
        o[c] = f2bf(d * rsqrtf(var + 1e-5f) * ln_g[g * 64 + lane] + ln_b[g * 64 + lane]); }
}

__constant__ int c_bucket[128] = {0, 1, 2, 3, 4, 5, 6, 7, 8, 9, 10, 11, 12, 13, 14, 15, 16, 16, 16, 17, 17, 18, 18, 18, 19, 19, 19, 20, 20, 20, 20, 21, 21, 21, 21, 22, 22, 22, 22, 22, 23, 23, 23, 23, 23, 23, 24, 24, 24, 24, 24, 24, 25, 25, 25, 25, 25, 25, 25, 26, 26, 26, 26, 26, 26, 26, 26, 27, 27, 27, 27, 27, 27, 27, 27, 27, 27, 28, 28, 28, 28, 28, 28, 28, 28, 28, 28, 29, 29, 29, 29, 29, 29, 29, 29, 29, 29, 29, 29, 30, 30, 30, 30, 30, 30, 30, 30, 30, 30, 30, 30, 30, 30, 31, 31, 31, 31, 31, 31, 31, 31, 31, 31, 31, 31, 31, 31, 31};

__global__ void __launch_bounds__(256) k_attn(const bf16* proj, const float* rel_bias, const float* sinks, float* att) {
    const int gw = blockIdx.x * 4 + (threadIdx.x >> 6), lane = threadIdx.x & 63;
    const int row = gw >> 3, h = gw & 7, kvh = h >> 2, t = row & 8191;
    const bf16* qp = proj + (size_t)row * 1792 + h * 64;
    const float L2E = 1.4426950408889634f;
    float lg[2];
#pragma unroll
    for (int jj = 0; jj < 2; ++jj) { const int dist = lane + jj * 64;
        if (dist <= t) { const bf16* kp = proj + (size_t)(row - dist) * 1792 + 512 + kvh * 64; float a = 0.f;
            for (int d = 0; d < 64; ++d) a += bf2f(qp[d]) * bf2f(kp[d]);
            lg[jj] = a + rel_bias[c_bucket[dist] * 8 + h] * L2E; }
        else lg[jj] = -1e30f; }
    const float sk = sinks[h] * L2E;
    float m = fmaxf(wave_max(fmaxf(lg[0], lg[1])), sk);
    const float p0 = (lg[0] > -1e29f) ? exp2f(lg[0] - m) : 0.f, p1 = (lg[1] > -1e29f) ? exp2f(lg[1] - m) : 0.f;
    const float den = wave_sum(p0 + p1) + exp2f(sk - m);
    float o = 0.f;
    for (int dist = 0; dist < 128; ++dist) { const float p = __shfl(dist < 64 ? p0 : p1, dist & 63);
        if (dist <= t) o += p * bf2f(proj[(size_t)(row - dist) * 1792 + 640 + kvh * 64 + lane]); }
    att[(size_t)row * 512 + h * 64 + lane] = o / den;
}
__global__ void __launch_bounds__(256) k_gmlp(const bf16* proj, const float* w_s, const float* b_s, float* gm) {
    const size_t idx = (size_t)blockIdx.x * 256 + threadIdx.x; const int row = (int)(idx >> 9), c = (int)(idx & 511), g = c >> 6, qi = row & 127, r0 = row - qi;
    const float* w = w_s + ((size_t)g * 128 + qi) * 128; float a = 0.f;
    for (int s = 0; s <= qi; ++s) a += w[s] * bf2f(proj[(size_t)(r0 + s) * 1792 + 1280 + c]);
    a += b_s[g * 128 + qi];
    gm[(size_t)row * 512 + c] = bf2f(proj[(size_t)row * 1792 + 768 + c]) * a;
}
__global__ void __launch_bounds__(256) k_mixnorm(const float* att, const float* gm, const float* ga, const float* gg, bf16* mixed) {
    const int row = blockIdx.x * 4 + (threadIdx.x >> 6), lane = threadIdx.x & 63;
    float a[8], g[8], sa = 0.f, sg = 0.f;
#pragma unroll
    for (int i = 0; i < 8; ++i) { a[i] = att[(size_t)row * 512 + i * 64 + lane]; g[i] = gm[(size_t)row * 512 + i * 64 + lane]; sa += a[i] * a[i]; sg += g[i] * g[i]; }
    const float ra = rsqrtf(wave_sum(sa) * (1.f / 512.f) + 1e-5f), rg = rsqrtf(wave_sum(sg) * (1.f / 512.f) + 1e-5f);
#pragma unroll
    for (int i = 0; i < 8; ++i) { mixed[(size_t)row * 1024 + i * 64 + lane] = f2bf(a[i] * ra * ga[i * 64 + lane]); mixed[(size_t)row * 1024 + 512 + i * 64 + lane] = f2bf(g[i] * rg * gg[i * 64 + lane]); }
}
__global__ void __launch_bounds__(256) k_ln(const float* res, const float* y, const float* mod, const float* lg, const float* lb, float* out, bf16* h2, int goff, int scoff, int shoff, int pad) {
    const int row = blockIdx.x * 4 + (threadIdx.x >> 6), lane = threadIdx.x & 63, b = row >> 13;
    float z[16], s = 0.f;
#pragma unroll
    for (int i = 0; i < 16; ++i) { const int c = i * 64 + lane; z[i] = 1.189207115002721f * res[(size_t)row * 1024 + c] + mod[b * 6144 + goff + c] * y[(size_t)row * 1024 + c]; s += z[i]; }
    const float mu = wave_sum(s) * (1.f / 1024.f); float q = 0.f;
#pragma unroll
    for (int i = 0; i < 16; ++i) { z[i] -= mu; q += z[i] * z[i]; }
    const float rstd = rsqrtf(wave_sum(q) * (1.f / 1024.f) + 1e-5f);
#pragma unroll
    for (int i = 0; i < 16; ++i) { const int c = i * 64 + lane; const float o = z[i] * rstd * lg[c] + lb[c]; out[(size_t)row * 1024 + c] = o;
        if (h2) h2[(size_t)row * 1024 + c] = f2bf(o * (1.0f + mod[b * 6144 + scoff + c]) + mod[b * 6144 + shoff + c]); }
}
}

static void naive_forward(void* const* d_in, float* out, unsigned char* ws, hipStream_t st, int lo, int hi) {
    const float* x = (const float*)d_in[0]; const float* c = (const float*)d_in[1]; const float* rel_bias = (const float*)d_in[2];
    const float* w_ada = (const float*)d_in[3]; const float* b_ada = (const float*)d_in[4]; const float* w_in = (const float*)d_in[5]; const float* b_in = (const float*)d_in[6];
    const float* sinks = (const float*)d_in[7]; const float* gln_g = (const float*)d_in[8]; const float* gln_b = (const float*)d_in[9];
    const float* w_s = (const float*)d_in[10]; const float* b_s = (const float*)d_in[11]; const float* ao_g = (const float*)d_in[12]; const float* go_g = (const float*)d_in[13];
    const float* w_out = (const float*)d_in[14]; const float* ln1_g = (const float*)d_in[15]; const float* ln1_b = (const float*)d_in[16];
    const float* w_gu = (const float*)d_in[17]; const float* w_d = (const float*)d_in[18]; const float* ln2_g = (const float*)d_in[19]; const float* ln2_b = (const float*)d_in[20];
    float* mod = (float*)(ws + WS_MOD); nv::bf16* proj = (nv::bf16*)(ws + WS_PROJ); nv::bf16* mixed = (nv::bf16*)(ws + WS_MIXED); nv::bf16* hb = (nv::bf16*)(ws + WS_H); nv::bf16* hid = (nv::bf16*)(ws + WS_HID);
    float* scr = (float*)(ws + WS_SCR); float* y2 = (float*)(ws + WS_Y2);
    if (lo <= 0 && 0 < hi) nv::k_mod<<<NMOD / 256, 256, 0, st>>>(c, w_ada, b_ada, mod);
    if (lo <= 1 && 1 < hi) {
        nv::k_gemm<nv::AModX, nv::ColId, nv::EpiF32><<<dim3(NIN / 128, MROWS / 128), 256, 0, st>>>(nv::AModX{x, mod}, w_in, nv::EpiF32{scr, NIN, 0}, NIN, DM);
        nv::k_proj_epi<<<MROWS / 4, 256, 0, st>>>(scr, b_in, gln_g, gln_b, proj, QSCALE, 0);
    }
    if (lo <= 2 && 2 < hi) {
        float* att = scr; float* gm = scr + (size_t)MROWS * 512;
        nv::k_attn<<<MROWS * 8 / 4, 256, 0, st>>>(proj, rel_bias, sinks, att);
        nv::k_gmlp<<<(unsigned)((size_t)MROWS * 512 / 256), 256, 0, st>>>(proj, w_s, b_s, gm);
        nv::k_mixnorm<<<MROWS / 4, 256, 0, st>>>(att, gm, ao_g, go_g, mixed);
    }
    if (lo <= 3 && 3 < hi) {
        nv::k_gemm<nv::ABf16, nv::ColId, nv::EpiF32><<<dim3(DM / 128, MROWS / 128), 256, 0, st>>>(nv::ABf16{mixed, DM, 0}, w_out, nv::EpiF32{scr, DM, 0}, DM, DM);
        nv::k_ln<<<MROWS / 4, 256, 0, st>>>(x, scr, mod, ln1_g, ln1_b, out, hb, 2048, 4096, 3072, 0);
    }
    if (lo <= 4 && 4 < hi)
        nv::k_gemm<nv::ABf16, nv::ColGU, nv::EpiSwiGLU><<<dim3(2 * DFF / 128, MROWS / 128), 256, 0, st>>>(nv::ABf16{hb, DM, 0}, w_gu, nv::EpiSwiGLU{hid}, 2 * DFF, DM);
    if (lo <= 5 && 5 < hi) {
        nv::k_gemm<nv::ABf16, nv::ColId, nv::EpiF32><<<dim3(DM / 128, MROWS / 128), 256, 0, st>>>(nv::ABf16{hid, DFF, 0}, w_d, nv::EpiF32{y2, DM, 0}, DM, DFF);
        nv::k_ln<<<MROWS / 4, 256, 0, st>>>(out, y2, mod, ln2_g, ln2_b, out, nullptr, 5120, 0, 0, 0);
    }
}

extern "C" void kernel_launch(void* const* d_in, const int* in_sizes, int n_in, void* d_out, int out_size, void* d_ws, size_t ws_size, hipStream_t stream) {
    if (n_in != 21 || out_size != MROWS * DM || ws_size < WS_END) { fprintf(stderr, "kernel_launch: unexpected shapes n_in %d out %d ws %zu\n", n_in, out_size, ws_size); return; }
    naive_forward(d_in, (float*)d_out, (unsigned char*)d_ws, stream, 0, 6);
}
```

```cpp
#include <hip/hip_runtime.h>
#include <cstdio>
#include <cstdint>
constexpr int BATCH = 8, SEQ = 8192, DM = 1024, MROWS = BATCH * SEQ;
constexpr int NIN = 1792, DFF = 2816, NMOD = 6144;
constexpr int PC_Q = 0, PC_K = 512, PC_V = 640, PC_GU = 768, PC_GV = 1280;
constexpr float QSCALE = 0.125f * 1.4426950408889634f;
constexpr float LOG2E = 1.4426950408889634f;
constexpr float ALPHA_F = 1.189207115002721f;
constexpr float LN_EPS = 1e-5f;
constexpr size_t MiB = 1u << 20;
constexpr size_t WS_CTL = 0, CTL_ZERO_BYTES = 1 * MiB;
constexpr size_t WS_MOD = 1 * MiB;
constexpr size_t WS_MODP = 1 * MiB + 256 * 1024;
constexpr size_t WS_WIN = 2 * MiB, WS_WOUT = 6 * MiB, WS_WGU = 8 * MiB, WS_WD = 19 * MiB, WS_WS = 25 * MiB;
constexpr size_t WS_X = 26 * MiB;
constexpr size_t WS_PROJ = 32 * MiB;
constexpr size_t WS_MIXED = 256 * MiB;
constexpr size_t WS_H = 384 * MiB;
constexpr size_t WS_HID = 512 * MiB;
constexpr size_t WS_END = 1024 * MiB;
constexpr size_t WS_SCR = 512 * MiB;
constexpr size_t WS_Y2 = 256 * MiB;


namespace pg8 {
#define PG8_LAS __attribute__((address_space(3)))
typedef unsigned short bf16_t;
typedef short bf16x8 __attribute__((ext_vector_type(8)));
typedef float f32x4 __attribute__((ext_vector_type(4)));
typedef unsigned u32x4 __attribute__((ext_vector_type(4)));
constexpr int BM = 256, BK = 64, HALF = 128, HTB = HALF * BK * 2  , STAGE_BYTES = 8 * HTB, NXCD = 8, WGM = 8;

__host__ __device__ __forceinline__ int lds_byte(int r, int c) { const int st = (r >> 4) * 2 + (c >> 5), rr = r & 15, cc = c & 31, ob = rr * 64 + cc * 2; return st * 1024 + (ob ^ (((ob >> 9) & 1) << 5)); }
__host__ __device__ __forceinline__ void stage_rc(int b, int& R, int& C) { const int st = b / 1024, sb = b % 1024, swz = sb ^ (((sb >> 9) & 1) << 5); R = (st >> 1) * 16 + swz / 64; C = (st & 1) * 32 + (swz % 64) / 2; }
__host__ __device__ __forceinline__ int perm32(int rho) { const int n = rho >> 4, i = rho & 15; return 8 * (i >> 2) + 4 * n + (i & 3); }

struct Unit { int pm, pn; };
struct Gemm { const bf16_t* A; const bf16_t* Bt; int M, N, K; };

struct StaticOrder {
    int nM, nN, nwg, G, c;
    __host__ __device__ void init(int M, int N, int G_, int c_) { nM = M / BM; nN = N / BM; nwg = nM * nN; G = G_; c = c_; }
    __host__ __device__ bool next(int i, Unit& u) const {
        const long L = (long)i * G + c; if (L >= nwg) return false;
        int wgid = (int)L; { const int q = nwg / NXCD, r = nwg % NXCD, xcd = wgid % NXCD, off = wgid / NXCD; wgid = (xcd < r ? xcd * (q + 1) : r * (q + 1) + (xcd - r) * q) + off; }
        const int nig = WGM * nN, gid = wgid / nig, fm = gid * WGM, gsz = (nM - fm) < WGM ? (nM - fm) : WGM;
        u.pm = fm + ((wgid % nig) % gsz); u.pn = (wgid % nig) / gsz; return true;
    }
    __device__ __forceinline__ void a_ready(const Unit&) const {}
    __device__ __forceinline__ void done(const Unit&) const {}
};

__device__ __forceinline__ unsigned cvt_pk_bf16(float lo, float hi) { unsigned r; asm volatile("v_cvt_pk_bf16_f32 %0, %1, %2" : "=v"(r) : "v"(lo), "v"(hi)); return r; }
typedef float f32x2 __attribute__((ext_vector_type(2)));
template <class Epi, class Sched, bool ALIGN_EPI = false, bool SP2 = false>
__device__ __forceinline__ void gemm_phase(PG8_LAS unsigned char* lds, const Gemm g, const Sched& S, const Epi& E) {
    int tid_ = threadIdx.x; asm volatile("" : "+v"(tid_));
    const int tid = tid_, wid = __builtin_amdgcn_readfirstlane(tid >> 6), lane = tid & 63, wr = wid >> 2, wc = wid & 3, fr = lane & 15, fq = lane >> 4;
    const int K = g.K, nt = K / BK;
    unsigned voffA[2], voffB[2];
#pragma unroll
    for (int i = 0; i < 2; ++i) { int R, C; stage_rc(tid * 16 + i * 8192, R, C); const int Rb = Epi::PERM ? ((R & ~31) + perm32(R & 31)) : R;
        voffA[i] = (unsigned)(R * K + C) * 2u; voffB[i] = (unsigned)(Rb * K + C) * 2u; }
    const size_t kstep = (size_t)(BK * 2);
    const size_t hstep = (size_t)HALF * K * 2;
    const size_t tstep = 2 * hstep;
    const unsigned ldsw = (unsigned)wid * 1024u;
    const int aoff = lds_byte(wr * 64 + fr, fq * 8), boff = lds_byte(wc * 32 + fr, fq * 8);
#define PG8_SA(b, h) (((b) * 2 + (h)) * HTB)
#define PG8_SB(b, h) ((4 + (b) * 2 + (h)) * HTB)
#define PG8_STAGE(bufoff, gbase, voff) do { _Pragma("unroll") for (int _i = 0; _i < 2; ++_i) \
        __builtin_amdgcn_global_load_lds((const unsigned*)((const char*)(gbase) + (voff)[_i]), (PG8_LAS unsigned*)(lds + (bufoff) + ldsw + _i * 8192), 16, 0, 0); } while (0)
#define PG8_LDA(dst, b, h) do { _Pragma("unroll") for (int m = 0; m < 4; ++m) _Pragma("unroll") for (int k = 0; k < 2; ++k) dst[m][k] = *(const PG8_LAS bf16x8*)(lds + PG8_SA(b, h) + aoff + m * 2048 + k * 1024); } while (0)
#define PG8_LDB(dst, b, h) do { _Pragma("unroll") for (int n = 0; n < 2; ++n) _Pragma("unroll") for (int k = 0; k < 2; ++k) dst[n][k] = *(const PG8_LAS bf16x8*)(lds + PG8_SB(b, h) + boff + n * 2048 + k * 1024); } while (0)
#define PG8_MMA(ai, bj, At, Bt) do { __builtin_amdgcn_s_setprio(1); _Pragma("unroll") for (int m = 0; m < 4; ++m) _Pragma("unroll") for (int n = 0; n < 2; ++n) _Pragma("unroll") for (int k = 0; k < 2; ++k) \
        acc[ai][bj][m][n] = __builtin_amdgcn_mfma_f32_16x16x32_bf16(Bt[n][k], At[m][k], acc[ai][bj][m][n], 0, 0, 0); __builtin_amdgcn_s_setprio(0); } while (0)
#define PG8_WAIT_V(n) asm volatile("s_waitcnt vmcnt(" #n ")" ::: "memory")
#define PG8_WAIT_L(n) asm volatile("s_waitcnt lgkmcnt(" #n ")" ::: "memory")
#define PG8_BAR __builtin_amdgcn_s_barrier()
#define PG8_SCHED __builtin_amdgcn_sched_barrier(0)
    Unit cur, nxt; int ui = 0;
    if (!S.next(0, cur)) return;
    f32x4 acc[2][2][4][2];
#pragma unroll
    for (int a = 0; a < 2; ++a)
#pragma unroll
        for (int b = 0; b < 2; ++b)
#pragma unroll
            for (int m = 0; m < 4; ++m)
#pragma unroll
                for (int n = 0; n < 2; ++n) acc[a][b][m][n] = (f32x4){0.f, 0.f, 0.f, 0.f};
    bf16x8 At[4][2], B0[2][2], B1[2][2];
    const char* cA = (const char*)g.A + (size_t)cur.pm * tstep; const char* cB = (const char*)g.Bt + (size_t)cur.pn * tstep;
    S.a_ready(cur);
    if constexpr (SP2) {
        PG8_STAGE(PG8_SB(0, 0), cB, voffB); PG8_STAGE(PG8_SB(0, 1), cB + hstep, voffB); PG8_STAGE(PG8_SA(0, 0), cA, voffA); PG8_STAGE(PG8_SA(0, 1), cA + hstep, voffA);
        if (wr == 1) PG8_BAR;
        PG8_WAIT_V(2); PG8_BAR;
        PG8_STAGE(PG8_SB(1, 0), cB + kstep, voffB); PG8_STAGE(PG8_SA(1, 0), cA + kstep, voffA); PG8_STAGE(PG8_SB(1, 1), cB + hstep + kstep, voffB);
        PG8_WAIT_V(6); PG8_BAR;
    } else {
        PG8_STAGE(PG8_SB(0, 0), cB, voffB); PG8_STAGE(PG8_SA(0, 0), cA, voffA); PG8_STAGE(PG8_SB(0, 1), cB + hstep, voffB); PG8_STAGE(PG8_SA(0, 1), cA + hstep, voffA);
        if (wr == 1) PG8_BAR;
        PG8_WAIT_V(4); PG8_BAR;
        PG8_STAGE(PG8_SB(1, 0), cB + kstep, voffB); PG8_STAGE(PG8_SA(1, 0), cA + kstep, voffA); PG8_STAGE(PG8_SB(1, 1), cB + hstep + kstep, voffB);
        PG8_WAIT_V(6); PG8_BAR;
    }
    for (;;) {
        const bool has_next = S.next(ui + 1, nxt);
        const char* nA = has_next ? (const char*)g.A + (size_t)nxt.pm * tstep : cA; const char* nB = has_next ? (const char*)g.Bt + (size_t)nxt.pn * tstep : cB;
        for (int t = 0; t < nt; t += 2) {
            const bool last = (t == nt - 2);
            const char* a1 = cA + (size_t)(t + 1) * kstep;
            const char* a2 = last ? nA : cA + (size_t)(t + 2) * kstep; const char* b2 = last ? nB : cB + (size_t)(t + 2) * kstep;
            const char* a3 = a2 + kstep; const char* b3 = b2 + kstep;
            if (last && has_next) S.a_ready(nxt);
            if constexpr (SP2) {
            PG8_LDB(B0, 0, 0); PG8_LDB(B1, 0, 1); PG8_SCHED; PG8_LDA(At, 0, 0); PG8_STAGE(PG8_SA(1, 1), a1 + hstep, voffA);
            PG8_WAIT_V(8); PG8_WAIT_L(0); PG8_BAR; PG8_MMA(0, 0, At, B0); PG8_MMA(0, 1, At, B1); PG8_BAR; PG8_SCHED;
            PG8_LDA(At, 0, 1); PG8_STAGE(PG8_SB(0, 0), b2, voffB); PG8_STAGE(PG8_SB(0, 1), b2 + hstep, voffB); PG8_STAGE(PG8_SA(0, 0), a2, voffA);
            PG8_WAIT_V(8); PG8_WAIT_L(0); PG8_BAR; PG8_MMA(1, 0, At, B0); PG8_MMA(1, 1, At, B1); PG8_BAR; PG8_SCHED;
            PG8_LDB(B0, 1, 0); PG8_LDB(B1, 1, 1); PG8_SCHED; PG8_LDA(At, 1, 0); PG8_STAGE(PG8_SA(0, 1), a2 + hstep, voffA);
            PG8_WAIT_V(8); PG8_WAIT_L(0); PG8_BAR; PG8_MMA(0, 0, At, B0); PG8_MMA(0, 1, At, B1); PG8_BAR; PG8_SCHED;
            PG8_LDA(At, 1, 1); PG8_STAGE(PG8_SB(1, 0), b3, voffB); PG8_STAGE(PG8_SB(1, 1), b3 + hstep, voffB); PG8_STAGE(PG8_SA(1, 0), a3, voffA);
            PG8_WAIT_V(8); PG8_WAIT_L(0); PG8_BAR; PG8_MMA(1, 0, At, B0); PG8_MMA(1, 1, At, B1); PG8_BAR; PG8_SCHED;
            } else {
            PG8_LDB(B0, 0, 0); PG8_SCHED; PG8_LDA(At, 0, 0); PG8_STAGE(PG8_SA(1, 1), a1 + hstep, voffA);
            PG8_WAIT_L(8); PG8_BAR; PG8_WAIT_L(0); PG8_MMA(0, 0, At, B0); PG8_BAR; PG8_SCHED;
            PG8_LDB(B1, 0, 1); PG8_STAGE(PG8_SB(0, 0), b2, voffB);
            PG8_BAR; PG8_WAIT_L(0); PG8_MMA(0, 1, At, B1); PG8_BAR;
            PG8_LDA(At, 0, 1); PG8_STAGE(PG8_SA(0, 0), a2, voffA);
            PG8_BAR; PG8_WAIT_L(0); PG8_MMA(1, 0, At, B0); PG8_BAR; PG8_SCHED;
            PG8_STAGE(PG8_SB(0, 1), b2 + hstep, voffB);
            PG8_WAIT_V(6); PG8_BAR; PG8_MMA(1, 1, At, B1); PG8_BAR;
            PG8_LDB(B0, 1, 0); PG8_SCHED; PG8_LDA(At, 1, 0); PG8_STAGE(PG8_SA(0, 1), a2 + hstep, voffA);
            PG8_WAIT_L(8); PG8_BAR; PG8_WAIT_L(0); PG8_MMA(0, 0, At, B0); PG8_BAR; PG8_SCHED;
            PG8_LDB(B1, 1, 1); PG8_STAGE(PG8_SB(1, 0), b3, voffB);
            PG8_BAR; PG8_WAIT_L(0); PG8_MMA(0, 1, At, B1); PG8_BAR;
            PG8_LDA(At, 1, 1); PG8_STAGE(PG8_SA(1, 0), a3, voffA);
            PG8_BAR; PG8_WAIT_L(0); PG8_MMA(1, 0, At, B0); PG8_BAR; PG8_SCHED;
            PG8_STAGE(PG8_SB(1, 1), b3 + hstep, voffB);
            PG8_WAIT_V(6); PG8_BAR; PG8_MMA(1, 1, At, B1); PG8_BAR;
            }
        }
        if constexpr (ALIGN_EPI) { if (wr == 0) PG8_BAR; }
        if constexpr (!Epi::AFTER_DRAIN) { E(acc, cur, wr, wc, fr, fq); S.done(cur); }
        if (!has_next) break;
#pragma unroll
        for (int a = 0; a < 2; ++a)
#pragma unroll
            for (int b = 0; b < 2; ++b)
#pragma unroll
                for (int m = 0; m < 4; ++m)
#pragma unroll
                    for (int n = 0; n < 2; ++n) acc[a][b][m][n] = (f32x4){0.f, 0.f, 0.f, 0.f};
        cur = nxt; cA = nA; cB = nB; ++ui;
        if constexpr (ALIGN_EPI) { if (wr == 1) PG8_BAR; }
    }
    PG8_WAIT_V(0);
    if constexpr (!ALIGN_EPI) { if (wr == 0) PG8_BAR; }
    PG8_BAR;
    if constexpr (Epi::AFTER_DRAIN) { E.fused(acc, cur, wr, wc, fr, fq, lds, wid, lane); S.done(cur); }
#undef PG8_SA
#undef PG8_SB
#undef PG8_STAGE
#undef PG8_LDA
#undef PG8_LDB
#undef PG8_MMA
#undef PG8_WAIT_V
#undef PG8_WAIT_L
#undef PG8_BAR
#undef PG8_SCHED
}
}

#define GAS __attribute__((address_space(1)))
#define LAS __attribute__((address_space(3)))
typedef unsigned short bf16;
typedef unsigned v4u __attribute__((ext_vector_type(4)));
typedef float f32x4 __attribute__((ext_vector_type(4)));
typedef short bf16x8 __attribute__((ext_vector_type(8)));
typedef GAS unsigned gu32;
typedef GAS unsigned long long gu64;
#define RLX_AGENT __ATOMIC_RELAXED, __HIP_MEMORY_SCOPE_AGENT
#define LDS_WAIT() asm volatile("s_waitcnt lgkmcnt(0)" ::: "memory")
#define VM_WAIT() asm volatile("s_waitcnt vmcnt(0)" ::: "memory")
__device__ __forceinline__ unsigned long long rt() { return __builtin_amdgcn_s_memrealtime(); }
__device__ __forceinline__ unsigned f2bf(float f) { unsigned u = __builtin_bit_cast(unsigned, f); return (u + 0x7fffu + ((u >> 16) & 1u)) >> 16; }
__device__ __forceinline__ unsigned pk2(float lo, float hi) { return f2bf(lo) | (f2bf(hi) << 16); }

#define XB_TMO      128
#define XB_XCNT(j)  (256  + 64 * (j))
#define XB_XSUB(j)  (1280 + 64 * (j))
#define XB_XGEN(j)  (2304 + 64 * (j))
#define XB_TOP      3328
#define XB_TOPGEN   3392
#define XCD_BAR_WORDS 3456
#define XB_SPIN_CAP (1u << 18)

__device__ __forceinline__ unsigned xb_ld(unsigned* p)              { return __hip_atomic_load(p, __ATOMIC_RELAXED, __HIP_MEMORY_SCOPE_AGENT); }
__device__ __forceinline__ unsigned xb_add(unsigned* p, unsigned v) { return __hip_atomic_fetch_add(p, v, __ATOMIC_RELAXED, __HIP_MEMORY_SCOPE_AGENT); }
__device__ __forceinline__ unsigned xb_xcc_id() { return (unsigned)__builtin_amdgcn_s_getreg((3 << 11) | 20) & 0xFu; }
#define XB_SPIN(cond, bar) do { unsigned _sp = 0; while (cond) { __builtin_amdgcn_s_sleep(1); \
    if ((++_sp & 255u) == 0u) { if (xb_ld(&(bar)[XB_TMO])) break; if (_sp > XB_SPIN_CAP) { atomicAdd(&(bar)[XB_TMO], 1u); break; } } } } while (0)

struct XcdBarrier {
    unsigned* bar; unsigned x;
    volatile LAS unsigned* st;
};

__device__ __forceinline__ XcdBarrier xcd_barrier_post(unsigned* bar, volatile LAS unsigned* st) {
    XcdBarrier b; b.bar = bar; b.x = xb_xcc_id(); b.st = st;
    if (threadIdx.x == 0) (void)xb_add(&bar[XB_XCNT(b.x)], 1u);
    return b;
}
__device__ __forceinline__ void xcd_barrier_complete(unsigned* bar, unsigned x, unsigned& nloc, unsigned& nx) {
    const unsigned G = gridDim.x * gridDim.y * gridDim.z;
    unsigned sum, cnt, mine, sp = 0u;
    for (;;) {
        sum = 0u; cnt = 0u; mine = 0u;
#pragma unroll
        for (unsigned j = 0; j < 16; ++j) { const unsigned c = xb_ld(&bar[XB_XCNT(j)]); sum += c; cnt += (c > 0u) ? 1u : 0u; mine = (j == x) ? c : mine; }
        if (sum == G) break;
        __builtin_amdgcn_s_sleep(1);
        if ((++sp & 255u) == 0u) { if (xb_ld(&bar[XB_TMO])) break; if (sp > XB_SPIN_CAP) { atomicAdd(&bar[XB_TMO], 1u); break; } }
    }
    nloc = mine > 0u ? mine : 1u; nx = cnt > 0u ? cnt : 1u;
}

__device__ __forceinline__ void xcd_barrier(const XcdBarrier& b) {
    asm volatile("s_waitcnt vmcnt(0)" ::: "memory");
    __syncthreads();
    if (threadIdx.x == 0) {
        unsigned* bar = b.bar;
        __builtin_amdgcn_s_waitcnt(0);
        unsigned nloc = b.st[0], nx = b.st[1];
        if (nloc == 0u) { xcd_barrier_complete(bar, b.x, nloc, nx); b.st[0] = nloc; b.st[1] = nx; }
        const unsigned old = xb_add(&bar[XB_XSUB(b.x)], 1u);
        const unsigned gen = old / nloc;
        if (old + 1u == (gen + 1u) * nloc) {
            __builtin_amdgcn_fence(__ATOMIC_RELEASE, "agent");
            asm volatile("s_waitcnt vmcnt(0)" ::: "memory");
            const unsigned og = xb_add(&bar[XB_TOP], 1u);
            const unsigned tg = og / nx;
            if (og + 1u == (tg + 1u) * nx) xb_add(&bar[XB_TOPGEN], 1u);
            else XB_SPIN(xb_ld(&bar[XB_TOPGEN]) == tg, bar);
            __builtin_amdgcn_fence(__ATOMIC_ACQUIRE, "agent");
            xb_add(&bar[XB_XGEN(b.x)], 1u);
            asm volatile("s_waitcnt vmcnt(0)" ::: "memory");
        } else {
            XB_SPIN(xb_ld(&bar[XB_XGEN(b.x)]) == gen, bar);
            __builtin_amdgcn_fence(__ATOMIC_ACQUIRE, "agent");
            asm volatile("s_waitcnt vmcnt(0)" ::: "memory");
        }
    }
    __syncthreads();
}

namespace pg8 {
__device__ __forceinline__ float gelu_t(float x) {
    const float z = x * (2.302208198f + 0.1029432397f * x * x);
    return x * __builtin_amdgcn_rcpf(1.0f + __builtin_amdgcn_exp2f(-z));
}
__device__ __forceinline__ float silu_f(float x) { return x * __builtin_amdgcn_rcpf(1.0f + __builtin_amdgcn_exp2f(-1.4426950408889634f * x)); }

struct EpiProj {
    static constexpr bool PERM = true, AFTER_DRAIN = false;
    bf16_t* P; const float* b_in; const float* ln_g; const float* ln_b;
    __device__ __forceinline__ void operator()(const f32x4 (&acc)[2][2][4][2], const Unit& u, int wr, int wc, int fr, int fq) const {
        const int row0 = u.pm * BM + wr * 64 + fr; const int pn = u.pn;
        if (pn < 5) {
            const int col0 = pn * BM + wc * 32 + 8 * fq;
            const float sc = pn < 2 ? QSCALE : 1.0f; const bool act = pn >= 3;
            f32x4 bv[2][2];
#pragma unroll
            for (int bj = 0; bj < 2; ++bj)
#pragma unroll
                for (int n = 0; n < 2; ++n) bv[bj][n] = *(const f32x4*)(b_in + col0 + bj * HALF + 4 * n);
#pragma unroll
            for (int ai = 0; ai < 2; ++ai)
#pragma unroll
                for (int m = 0; m < 4; ++m) { bf16_t* rowp = P + (size_t)(row0 + ai * HALF + m * 16) * NIN + col0;
#pragma unroll
                    for (int bj = 0; bj < 2; ++bj) { f32x4 v0 = acc[ai][bj][m][0] + bv[bj][0], v1 = acc[ai][bj][m][1] + bv[bj][1];
                        if (act) {
#pragma unroll
                            for (int i = 0; i < 4; ++i) { v0[i] = gelu_t(v0[i]); v1[i] = gelu_t(v1[i]); } }
                        v0 = v0 * sc; v1 = v1 * sc; u32x4 w; w.x = cvt_pk_bf16(v0[0], v0[1]); w.y = cvt_pk_bf16(v0[2], v0[3]); w.z = cvt_pk_bf16(v1[0], v1[1]); w.w = cvt_pk_bf16(v1[2], v1[3]);
                        *(u32x4*)(rowp + bj * HALF) = w; } }
        } else {
            const int lc0 = pn * BM + 64 * wc + 8 * fq;
            f32x4 bv[2][2];
#pragma unroll
            for (int bj = 0; bj < 2; ++bj)
#pragma unroll
                for (int n = 0; n < 2; ++n) bv[bj][n] = *(const f32x4*)(b_in + lc0 + 32 * bj + 4 * n);
#pragma unroll
            for (int ai = 0; ai < 2; ++ai)
#pragma unroll
                for (int m = 0; m < 4; ++m) { bf16_t* rowp = P + (size_t)(row0 + ai * HALF + m * 16) * NIN + lc0;
                    f32x4 v[2][2]; float s = 0.f;
#pragma unroll
                    for (int bj = 0; bj < 2; ++bj)
#pragma unroll
                        for (int n = 0; n < 2; ++n) { f32x4 t = acc[ai][bj][m][n] + bv[bj][n];
#pragma unroll
                            for (int i = 0; i < 4; ++i) t[i] = gelu_t(t[i]);
                            v[bj][n] = t; s += (t[0] + t[1]) + (t[2] + t[3]); }
                    s += __shfl_xor(s, 16); s += __shfl_xor(s, 32);
                    const float mu = s * (1.0f / 64.0f); float q = 0.f;
#pragma unroll
                    for (int bj = 0; bj < 2; ++bj)
#pragma unroll
                        for (int n = 0; n < 2; ++n) { v[bj][n] = v[bj][n] - mu; const f32x4 d = v[bj][n]; q += (d[0] * d[0] + d[1] * d[1]) + (d[2] * d[2] + d[3] * d[3]); }
                    q += __shfl_xor(q, 16); q += __shfl_xor(q, 32);
                    const float rstd = __builtin_amdgcn_rsqf(q * (1.0f / 64.0f) + LN_EPS);
#pragma unroll
                    for (int bj = 0; bj < 2; ++bj) { const f32x4 g0 = *(const f32x4*)(ln_g + (lc0 - PC_GV) + 32 * bj), g1 = *(const f32x4*)(ln_g + (lc0 - PC_GV) + 32 * bj + 4);
                        const f32x4 b0 = *(const f32x4*)(ln_b + (lc0 - PC_GV) + 32 * bj), b1 = *(const f32x4*)(ln_b + (lc0 - PC_GV) + 32 * bj + 4);
                        const f32x4 o0 = v[bj][0] * rstd * g0 + b0, o1 = v[bj][1] * rstd * g1 + b1;
                        u32x4 w; w.x = cvt_pk_bf16(o0[0], o0[1]); w.y = cvt_pk_bf16(o0[2], o0[3]); w.z = cvt_pk_bf16(o1[0], o1[1]); w.w = cvt_pk_bf16(o1[2], o1[3]);
                        *(u32x4*)(rowp + 32 * bj) = w; } }
        }
    }
};
struct EpiSwiGLU {
    static constexpr bool PERM = true, AFTER_DRAIN = false;
    bf16_t* H;
    __device__ __forceinline__ void operator()(const f32x4 (&acc)[2][2][4][2], const Unit& u, int wr, int wc, int fr, int fq) const {
        const int row0 = u.pm * BM + wr * 64 + fr, hc0 = u.pn * HALF + wc * 32 + 8 * fq;
#pragma unroll
        for (int ai = 0; ai < 2; ++ai)
#pragma unroll
            for (int m = 0; m < 4; ++m) { f32x4 h0, h1;
#pragma unroll
                for (int i = 0; i < 4; ++i) { h0[i] = silu_f(acc[ai][0][m][0][i]) * acc[ai][1][m][0][i]; h1[i] = silu_f(acc[ai][0][m][1][i]) * acc[ai][1][m][1][i]; }
                u32x4 w; w.x = cvt_pk_bf16(h0[0], h0[1]); w.y = cvt_pk_bf16(h0[2], h0[3]); w.z = cvt_pk_bf16(h1[0], h1[1]); w.w = cvt_pk_bf16(h1[2], h1[3]);
                *(u32x4*)(H + (size_t)(row0 + ai * HALF + m * 16) * DFF + hc0) = w; }
    }
};
struct EpiF32 {
    static constexpr bool PERM = false, AFTER_DRAIN = false;
    float* C; int ldc;
    __device__ __forceinline__ void operator()(const f32x4 (&acc)[2][2][4][2], const Unit& u, int wr, int wc, int fr, int fq) const {
        const int row0 = u.pm * BM + wr * 64 + fr, col0 = u.pn * BM + wc * 32 + 4 * fq;
#pragma unroll
        for (int ai = 0; ai < 2; ++ai)
#pragma unroll
            for (int m = 0; m < 4; ++m) { float* rowp = C + (size_t)(row0 + ai * HALF + m * 16) * ldc + col0;
#pragma unroll
                for (int bj = 0; bj < 2; ++bj)
#pragma unroll
                    for (int n = 0; n < 2; ++n) *(f32x4*)(rowp + bj * HALF + n * 16) = acc[ai][bj][m][n]; }
    }
};
}

namespace tmx {
#define TM_LAS __attribute__((address_space(3)))
typedef short bf16x8 __attribute__((ext_vector_type(8)));
typedef short s16x4 __attribute__((ext_vector_type(4)));
typedef float f32x16 __attribute__((ext_vector_type(16)));
typedef unsigned u32x4 __attribute__((ext_vector_type(4)));
typedef unsigned u32x2 __attribute__((ext_vector_type(2)));
typedef unsigned short bf16_t;
constexpr int L_K = 0, L_V = 65536, L_G = 0, L_TB = 131072 + 1024;
constexpr int TBN = 192;
__constant__ int c_bucket2[128] = {0, 1, 2, 3, 4, 5, 6, 7, 8, 9, 10, 11, 12, 13, 14, 15, 16, 16, 16, 17, 17, 18, 18, 18, 19, 19, 19, 20, 20, 20, 20, 21, 21, 21, 21, 22, 22, 22, 22, 22, 23, 23, 23, 23, 23, 23, 24, 24, 24, 24, 24, 24, 25, 25, 25, 25, 25, 25, 25, 26, 26, 26, 26, 26, 26, 26, 26, 27, 27, 27, 27, 27, 27, 27, 27, 27, 27, 28, 28, 28, 28, 28, 28, 28, 28, 28, 28, 29, 29, 29, 29, 29, 29, 29, 29, 29, 29, 29, 29, 30, 30, 30, 30, 30, 30, 30, 30, 30, 30, 30, 30, 30, 30, 31, 31, 31, 31, 31, 31, 31, 31, 31, 31, 31, 31, 31, 31, 31};

__device__ __forceinline__ unsigned cvtpk(float lo, float hi) { unsigned r; asm volatile("v_cvt_pk_bf16_f32 %0, %1, %2" : "=v"(r) : "v"(lo), "v"(hi)); return r; }
__device__ __forceinline__ float bflo(unsigned w) { return __uint_as_float(w << 16); }
__device__ __forceinline__ float bfhi(unsigned w) { return __uint_as_float(w & 0xffff0000u); }
__device__ __forceinline__ s16x4 trrd(TM_LAS const char* p) { typedef short v4i16_t __attribute__((ext_vector_type(4))); return __builtin_bit_cast(s16x4, __builtin_amdgcn_ds_read_tr16_b64_v4i16((TM_LAS v4i16_t*)p)); }
__device__ __forceinline__ float wsum(float v) {
#pragma unroll
    for (int o = 1; o < 64; o <<= 1) v += __shfl_xor(v, o);
    return v; }

struct Params { const bf16_t* proj; bf16_t* mixed; const bf16_t* wsp; const float* rel_bias; const float* sinks; const float* b_s; const float* ao_g; const float* go_g; };

template <int J> __device__ __forceinline__ void attn_qblock(TM_LAS const char* lds, const Params& p, int r0, bool first_blk, int h, int lane, float sink2) {
    const int r32 = lane & 31, hi = lane >> 5, kvh = h >> 2;
    const bf16_t* qrow = p.proj + (size_t)(r0 + 32 * J + r32) * NIN + PC_Q + 64 * h + 8 * hi;
    bf16x8 qr[4];
#pragma unroll
    for (int ks = 0; ks < 4; ++ks) qr[ks] = *(const bf16x8*)(qrow + 16 * ks);
    unsigned tb_a = (unsigned)(uintptr_t)(lds + L_TB) + 4u * (unsigned)(h * TBN + (r32 - 4 * hi));
    unsigned kb_a = (unsigned)(uintptr_t)(lds + L_K) + (unsigned)((kvh * 8 + hi) * 4096 + r32 * 16);
    unsigned vb_a = (unsigned)(uintptr_t)(lds + L_V) + (unsigned)(kvh * 32768 + (4 * hi + ((lane & 15) >> 2)) * 64 + ((lane >> 4) & 1) * 32 + (lane & 3) * 8);
    asm volatile("" : "+v"(tb_a), "+v"(kb_a), "+v"(vb_a));
    TM_LAS const float* tb = (TM_LAS const float*)tb_a; TM_LAS const char* kb = (TM_LAS const char*)kb_a; TM_LAS const char* vb = (TM_LAS const char*)vb_a;
    f32x16 S[5];
#pragma unroll
    for (int d = 0; d < 5; ++d) {
        const int t = J + d;
        const bool valid = (t >= 4) || !first_blk;
        if (valid) {
#pragma unroll
            for (int r = 0; r < 16; ++r) S[d][r] = tb[159 - 32 * d - (r & 3) - 8 * (r >> 2)];
#pragma unroll
            for (int ks = 0; ks < 4; ++ks) { const bf16x8 kf = *(TM_LAS const bf16x8*)(kb + (2 * ks) * 4096 + (32 * t) * 16);
                S[d] = __builtin_amdgcn_mfma_f32_32x32x16_bf16(kf, qr[ks], S[d], 0, 0, 0); }
        } else {
#pragma unroll
            for (int r = 0; r < 16; ++r) S[d][r] = -1e30f;
        }
    }
    float mx = sink2;
#pragma unroll
    for (int d = 0; d < 5; ++d)
#pragma unroll
        for (int r = 0; r < 16; ++r) mx = fmaxf(mx, S[d][r]);
    mx = fmaxf(mx, __shfl_xor(mx, 32));
    float l = 0.f;
#pragma unroll
    for (int d = 0; d < 5; ++d)
#pragma unroll
        for (int r = 0; r < 16; ++r) { const float e = __builtin_amdgcn_exp2f(S[d][r] - mx); S[d][r] = e; l += e; }
    l += __shfl_xor(l, 32);
    l += __builtin_amdgcn_exp2f(sink2 - mx);
    f32x16 o[2];
#pragma unroll
    for (int r = 0; r < 16; ++r) { o[0][r] = 0.f; o[1][r] = 0.f; }
#pragma unroll
    for (int d = 0; d < 5; ++d) {
        const int t = J + d; const bool valid = (t >= 4) || !first_blk;
        if (valid) {
#pragma unroll
            for (int s = 0; s < 2; ++s) {
                u32x4 pw; pw.x = cvtpk(S[d][8 * s + 0], S[d][8 * s + 1]); pw.y = cvtpk(S[d][8 * s + 2], S[d][8 * s + 3]); pw.z = cvtpk(S[d][8 * s + 4], S[d][8 * s + 5]); pw.w = cvtpk(S[d][8 * s + 6], S[d][8 * s + 7]);
                const bf16x8 pa = __builtin_bit_cast(bf16x8, pw);
#pragma unroll
                for (int d0 = 0; d0 < 2; ++d0) { const s16x4 lo = trrd(vb + d0 * 16384 + (32 * t + 16 * s) * 64), hh = trrd(vb + d0 * 16384 + (32 * t + 16 * s + 8) * 64);
                    const bf16x8 vf = (bf16x8){lo[0], lo[1], lo[2], lo[3], hh[0], hh[1], hh[2], hh[3]};
                    o[d0] = __builtin_amdgcn_mfma_f32_32x32x16_bf16(vf, pa, o[d0], 0, 0, 0); }
            }
        }
    }
    const float inv = __builtin_amdgcn_rcpf(l);
    bf16_t* orow = p.mixed + (size_t)(r0 + 32 * J + r32) * DM + 64 * h + 4 * hi;
#pragma unroll
    for (int d0 = 0; d0 < 2; ++d0)
#pragma unroll
        for (int k = 0; k < 4; ++k) { u32x2 w; w.x = cvtpk(o[d0][4 * k] * inv, o[d0][4 * k + 1] * inv); w.y = cvtpk(o[d0][4 * k + 2] * inv, o[d0][4 * k + 3] * inv);
            *(u32x2*)(orow + 32 * d0 + 8 * k) = w; }
}

template <int J> __device__ __forceinline__ void gmlp_block(TM_LAS const char* ldsg, const Params& p, int r0, int g, int lane) {
    const int r32 = lane & 31, hi = lane >> 5;
    const bf16_t* wrow = p.wsp + ((size_t)g * 128 + 32 * J + r32) * 128 + 8 * hi;
    unsigned gb_a = (unsigned)(uintptr_t)ldsg + (unsigned)((4 * hi + ((lane & 15) >> 2)) * 64 + ((lane >> 4) & 1) * 32 + (lane & 3) * 8);
    asm volatile("" : "+v"(gb_a));
    TM_LAS const char* gb = (TM_LAS const char*)gb_a;
    f32x16 a[2];
#pragma unroll
    for (int r = 0; r < 16; ++r) { a[0][r] = 0.f; a[1][r] = 0.f; }
#pragma unroll
    for (int ks = 0; ks < 2 * (J + 1); ++ks) {
        const bf16x8 wf = *(const bf16x8*)(wrow + 16 * ks);
#pragma unroll
        for (int d0 = 0; d0 < 2; ++d0) { const s16x4 lo = trrd(gb + d0 * 8192 + (16 * ks) * 64), hh = trrd(gb + d0 * 8192 + (16 * ks + 8) * 64);
            const bf16x8 gf = (bf16x8){lo[0], lo[1], lo[2], lo[3], hh[0], hh[1], hh[2], hh[3]};
            a[d0] = __builtin_amdgcn_mfma_f32_32x32x16_bf16(gf, wf, a[d0], 0, 0, 0); }
    }
    const int row = r0 + 32 * J + r32;
    const float bs = p.b_s[g * 128 + 32 * J + r32];
    const bf16_t* urow = p.proj + (size_t)row * NIN + PC_GU + 64 * g + 4 * hi;
    bf16_t* orow = p.mixed + (size_t)row * DM + 512 + 64 * g + 4 * hi;
#pragma unroll
    for (int d0 = 0; d0 < 2; ++d0)
#pragma unroll
        for (int k = 0; k < 4; ++k) { const u32x2 uu = *(const u32x2*)(urow + 32 * d0 + 8 * k);
            u32x2 w; w.x = cvtpk((a[d0][4 * k] + bs) * bflo(uu.x), (a[d0][4 * k + 1] + bs) * bfhi(uu.x)); w.y = cvtpk((a[d0][4 * k + 2] + bs) * bflo(uu.y), (a[d0][4 * k + 3] + bs) * bfhi(uu.y));
            *(u32x2*)(orow + 32 * d0 + 8 * k) = w; }
}

__device__ __forceinline__ void phase(TM_LAS char* lds, const Params& p, int vcu, int G) {
    int tid_ = threadIdx.x; asm volatile("" : "+v"(tid_));
    const int tid = tid_, lane = tid & 63, wid = __builtin_amdgcn_readfirstlane(tid >> 6);
    for (int i = tid; i < 8 * TBN; i += 512) { const int h = i / TBN, dist = i % TBN - 31;
        ((TM_LAS float*)(lds + L_TB))[i] = (dist >= 0 && dist < 128) ? p.rel_bias[c_bucket2[dist] * 8 + h] * LOG2E : -1e30f; }
    const float sink2 = p.sinks[wid] * LOG2E;
    f32x4 ga[2], gg[2];
    ga[0] = *(const f32x4*)(p.ao_g + 8 * lane); ga[1] = *(const f32x4*)(p.ao_g + 8 * lane + 4); gg[0] = *(const f32x4*)(p.go_g + 8 * lane); gg[1] = *(const f32x4*)(p.go_g + 8 * lane + 4);
    const int nunits = MROWS / 128;
#pragma unroll 1
    for (int unit = vcu * (nunits / G); unit < (vcu + 1) * (nunits / G); ++unit) {
        const int r0 = unit * 128; const bool first_blk = (unit & 63) == 0;
#pragma unroll
        for (int i = 0; i < 8; ++i) { const int pk = wid * 8 + i, kvh = pk >> 5, c = (pk >> 2) & 7, qt = pk & 3;
            if (qt >= 2 || !first_blk)
                __builtin_amdgcn_global_load_lds((const unsigned*)(p.proj + (size_t)(r0 - 128 + qt * 64 + lane) * NIN + PC_K + kvh * 64 + c * 8), (TM_LAS unsigned*)(lds + L_K + ((kvh * 8 + c) * 256 + qt * 64) * 16), 16, 0, 0); }
#pragma unroll
        for (int i = 0; i < 8; ++i) { const int pv = wid * 8 + i, kvh = pv >> 5, dh = (pv >> 4) & 1, grp = pv & 15;
            if (grp >= 8 || !first_blk)
                __builtin_amdgcn_global_load_lds((const unsigned*)(p.proj + (size_t)(r0 - 128 + grp * 16 + (lane >> 2)) * NIN + PC_V + kvh * 64 + dh * 32 + (lane & 3) * 8), (TM_LAS unsigned*)(lds + L_V + ((kvh * 2 + dh) * 256 + grp * 16) * 64), 16, 0, 0); }
        asm volatile("s_waitcnt vmcnt(0)" ::: "memory");
        __syncthreads();
        attn_qblock<0>(lds, p, r0, first_blk, wid, lane, sink2);
        attn_qblock<1>(lds, p, r0, first_blk, wid, lane, sink2);
        attn_qblock<2>(lds, p, r0, first_blk, wid, lane, sink2);
        attn_qblock<3>(lds, p, r0, first_blk, wid, lane, sink2);
        __syncthreads();
        TM_LAS char* ldsg = lds + L_G + wid * 16384;
#pragma unroll
        for (int i = 0; i < 16; ++i) { const int dh = i >> 3, grp = i & 7;
            __builtin_amdgcn_global_load_lds((const unsigned*)(p.proj + (size_t)(r0 + grp * 16 + (lane >> 2)) * NIN + PC_GV + wid * 64 + dh * 32 + (lane & 3) * 8), (TM_LAS unsigned*)(ldsg + (dh * 128 + grp * 16) * 64), 16, 0, 0); }
        asm volatile("s_waitcnt vmcnt(0)" ::: "memory");
        gmlp_block<0>(ldsg, p, r0, wid, lane);
        gmlp_block<1>(ldsg, p, r0, wid, lane);
        gmlp_block<2>(ldsg, p, r0, wid, lane);
        gmlp_block<3>(ldsg, p, r0, wid, lane);
        asm volatile("s_waitcnt vmcnt(0)" ::: "memory");
        __syncthreads();
#pragma unroll 2
        for (int rr = 0; rr < 16; ++rr) { bf16_t* rowp = p.mixed + (size_t)(r0 + wid * 16 + rr) * DM + 8 * lane;
            const u32x4 av = *(const u32x4*)rowp, gv = *(const u32x4*)(rowp + 512);
            float a[8] = {bflo(av.x), bfhi(av.x), bflo(av.y), bfhi(av.y), bflo(av.z), bfhi(av.z), bflo(av.w), bfhi(av.w)};
            float g[8] = {bflo(gv.x), bfhi(gv.x), bflo(gv.y), bfhi(gv.y), bflo(gv.z), bfhi(gv.z), bflo(gv.w), bfhi(gv.w)};
            float sa = 0.f, sg = 0.f;
#pragma unroll
            for (int i = 0; i < 8; ++i) { sa += a[i] * a[i]; sg += g[i] * g[i]; }
            const float ra = __builtin_amdgcn_rsqf(wsum(sa) * (1.0f / 512.0f) + LN_EPS), rg = __builtin_amdgcn_rsqf(wsum(sg) * (1.0f / 512.0f) + LN_EPS);
            u32x4 wa, wg;
            wa.x = cvtpk(a[0] * ra * ga[0][0], a[1] * ra * ga[0][1]); wa.y = cvtpk(a[2] * ra * ga[0][2], a[3] * ra * ga[0][3]); wa.z = cvtpk(a[4] * ra * ga[1][0], a[5] * ra * ga[1][1]); wa.w = cvtpk(a[6] * ra * ga[1][2], a[7] * ra * ga[1][3]);
            wg.x = cvtpk(g[0] * rg * gg[0][0], g[1] * rg * gg[0][1]); wg.y = cvtpk(g[2] * rg * gg[0][2], g[3] * rg * gg[0][3]); wg.z = cvtpk(g[4] * rg * gg[1][0], g[5] * rg * gg[1][1]); wg.w = cvtpk(g[6] * rg * gg[1][2], g[7] * rg * gg[1][3]);
            *(u32x4*)rowp = wa; *(u32x4*)(rowp + 512) = wg; }
    }
}
}

constexpr int NWAVES = 8;
#ifndef MK_PER_PHASE
#define MK_PER_PHASE 0
#endif
#ifndef FUSED_LN
#define FUSED_LN 0
#endif
constexpr int N_PHASES = 9;
constexpr int CW_TMO = 0, CW_CODE = 1, CW_BAR = 4096, CW_SEAM = 16384, SEAM_BANK = 256 * 64;
constexpr int RING_OFF = 0, RING_BYTES = 131072, LDSCTL_OFF = RING_BYTES, MISC_OFF = LDSCTL_OFF + 320;
constexpr int LDS_BYTES = 131072 + 1024 + 6144 + 16384;
constexpr int XLDS_OFF = 131072 + 1024 + 6144;
constexpr size_t WS_MODP_F = WS_PROJ;
constexpr size_t WS_Y1 = WS_HID;
constexpr int KSPLIT = 32;

struct Frame {
    LAS unsigned char* lds; volatile LAS unsigned* MISC; gu32* ctl;
    int tid, lane, wave, vcu, G;
};
__device__ __forceinline__ float wave_sum(float v) {
#pragma unroll
    for (int o = 1; o < 64; o <<= 1) v += __shfl_xor(v, o);
    return v; }
__device__ __forceinline__ void p0_transpose_item(const float* W, int K, int N, bf16* WT, int dst_row0, LAS float* scr, int k0, int n0, int lane) {
#pragma unroll 8
    for (int i = 0; i < 32; ++i) { const int kk = 2 * i + (lane >> 5); scr[kk * 33 + (lane & 31)] = W[(size_t)(k0 + kk) * N + n0 + (lane & 31)]; }
    LDS_WAIT(); asm volatile("" ::: "memory");
    const int c = lane & 7;
#pragma unroll
    for (int j = 0; j < 4; ++j) { const int n = (lane >> 3) + 8 * j; const LAS float* s = scr + (8 * c) * 33 + n;
        v4u o; o.x = pk2(s[0 * 33], s[1 * 33]); o.y = pk2(s[2 * 33], s[3 * 33]); o.z = pk2(s[4 * 33], s[5 * 33]); o.w = pk2(s[6 * 33], s[7 * 33]);
        *(GAS v4u*)(WT + (size_t)(dst_row0 + n) * K + k0 + 8 * c) = o; }
    LDS_WAIT(); asm volatile("" ::: "memory");
}
struct In { const float *x, *c, *rel_bias, *w_ada, *b_ada, *w_in, *b_in, *sinks, *gln_g, *gln_b, *w_s, *b_s, *ao_g, *go_g, *w_out, *ln1_g, *ln1_b, *w_gu, *w_d, *ln2_g, *ln2_b; };

__device__ __forceinline__ void p0_prologue(Frame& F, const In& I, unsigned char* ws) {
    LAS float* scr = (LAS float*)(F.lds + RING_OFF + F.wave * 16384);
    const int gw = F.vcu * NWAVES + F.wave, NGW = F.G * NWAVES;
    bf16* Win = (bf16*)(ws + WS_WIN); bf16* Wout = (bf16*)(ws + WS_WOUT); bf16* Wgu = (bf16*)(ws + WS_WGU); bf16* Wd = (bf16*)(ws + WS_WD); bf16* Wsp = (bf16*)(ws + WS_WS);
    constexpr int I_IN = (DM / 64) * (NIN / 32), I_OUT = (DM / 64) * (DM / 32), I_GU = (DM / 64) * (2 * DFF / 32), I_D = (DFF / 64) * (DM / 32), I_MOD = 24 * KSPLIT;
    constexpr int NITEMS = I_MOD + I_IN + I_OUT + I_GU + I_D;
    for (int it = gw; it < NITEMS; it += NGW) {
        int r = it;
        if (r < I_MOD) {
            const int cg = r % 24, ks = r / 24, n = cg * 256 + 4 * F.lane, kb = ks * (DM / KSPLIT);
            f32x4 acc[8];
#pragma unroll
            for (int b = 0; b < 8; ++b) acc[b] = (f32x4){0.f, 0.f, 0.f, 0.f};
#pragma unroll 4
            for (int k = 0; k < DM / KSPLIT; ++k) { const f32x4 w = *(const GAS f32x4*)(I.w_ada + (size_t)(kb + k) * NMOD + n);
#pragma unroll
                for (int b = 0; b < 8; ++b) { const float cv = I.c[b * DM + kb + k]; const float s = cv / (1.0f + __expf(-cv)); acc[b] = acc[b] + w * s; } }
            float* mp = (float*)(ws + WS_MODP_F);
#pragma unroll
            for (int b = 0; b < 8; ++b) *(GAS f32x4*)(mp + ((size_t)ks * 8 + b) * NMOD + n) = acc[b];
            continue; }
        r -= I_MOD;
        if (r < I_IN) { const int nb = r % (NIN / 32), kb = r / (NIN / 32), n0 = 32 * nb; int dst = n0;
            if (n0 >= PC_GV) { const int L = (n0 - PC_GV) & 255, tile = (n0 - PC_GV) >> 8; dst = PC_GV + 256 * tile + 128 * ((L >> 5) & 1) + 32 * (L >> 6); }
            p0_transpose_item(I.w_in, DM, NIN, Win, dst, scr, 64 * kb, n0, F.lane); continue; }
        r -= I_IN;
        if (r < I_OUT) { const int nb = r % (DM / 32), kb = r / (DM / 32); p0_transpose_item(I.w_out, DM, DM, Wout, 32 * nb, scr, 64 * kb, 32 * nb, F.lane); continue; }
        r -= I_OUT;
        if (r < I_GU) { const int nb = r % (2 * DFF / 32), kb = r / (2 * DFF / 32), n0 = 32 * nb; const int bj = n0 >= DFF ? 1 : 0, hc = n0 - bj * DFF;
            p0_transpose_item(I.w_gu, DM, 2 * DFF, Wgu, 256 * (hc >> 7) + 128 * bj + (hc & 127), scr, 64 * kb, n0, F.lane); continue; }
        r -= I_GU;
        { const int nb = r % (DM / 32), kb = r / (DM / 32); p0_transpose_item(I.w_d, DFF, DM, Wd, 32 * nb, scr, 64 * kb, 32 * nb, F.lane); }
    }
    for (int e = (F.vcu * NWAVES * 64 + F.tid); e < 8 * 128 * 128; e += F.G * NWAVES * 64) { const int kk = e & 127, t = (e >> 7) & 127, j = kk & 7, h = (kk >> 3) & 1, ks = kk >> 4;
        const int s = 16 * ks + 8 * (j >> 2) + 4 * h + (j & 3); Wsp[e] = (bf16)(s <= t ? f2bf(I.w_s[(e & ~127) + s]) : 0u); }
}
__device__ __forceinline__ void p1_hpass(Frame& F, const In& I, unsigned char* ws) {
    const float* mp = (const float*)(ws + WS_MODP_F); float* mod = (float*)(ws + WS_MOD); bf16* H = (bf16*)(ws + WS_H);
    LAS float* lm = (LAS float*)(F.lds + RING_OFF);
    const int b = F.vcu >> 5;
    for (int i = F.tid; i < 2048; i += NWAVES * 64) { float s = I.b_ada[i];
#pragma unroll 8
        for (int ks = 0; ks < KSPLIT; ++ks) s += mp[((size_t)ks * 8 + b) * NMOD + i];
        lm[i] = s; }
    if (F.tid < 192) { const int e = F.vcu * 192 + F.tid, bb = e / NMOD, n = e % NMOD; float s = I.b_ada[n];
#pragma unroll 8
        for (int ks = 0; ks < KSPLIT; ++ks) s += mp[((size_t)ks * 8 + bb) * NMOD + n];
        mod[e] = s; }
    __syncthreads();
    for (int rr = 0; rr < 32; ++rr) { const int row = F.vcu * 256 + F.wave * 32 + rr;
        const GAS f32x4* xr = (const GAS f32x4*)(I.x + (size_t)row * DM) + F.lane; GAS unsigned long long* o8 = (GAS unsigned long long*)(H + (size_t)row * DM) + F.lane;
#pragma unroll
        for (int j = 0; j < 4; ++j) { const f32x4 v = xr[64 * j]; const f32x4 sh = *(const LAS f32x4*)(lm + 256 * j + 4 * F.lane), sc = *(const LAS f32x4*)(lm + 1024 + 256 * j + 4 * F.lane);
            const f32x4 h = v * (sc + 1.0f) + sh; o8[64 * j] = (unsigned long long)pk2(h.x, h.y) | ((unsigned long long)pk2(h.z, h.w) << 32); } }
    __syncthreads();
}
__device__ __forceinline__ void ln_pass(Frame& F, const float* res, const float* y, const float* mod, int goff, const float* lg, const float* lb, float* out, bf16* h2, int scoff, int shoff) {
    const int gw = F.vcu * NWAVES + F.wave, NGW = F.G * NWAVES;
    for (int row = gw; row < MROWS; row += NGW) { const int b = row >> 13; const float* mb = mod + b * NMOD;
        f32x4 z[4]; float s = 0.f;
#pragma unroll
        for (int j = 0; j < 4; ++j) { const int c = 256 * j + 4 * F.lane; const f32x4 r = *(const GAS f32x4*)(res + (size_t)row * DM + c), yy = *(const GAS f32x4*)(y + (size_t)row * DM + c), g = *(const GAS f32x4*)(mb + goff + c);
            z[j] = r * ALPHA_F + g * yy; s += (z[j].x + z[j].y) + (z[j].z + z[j].w); }
        const float mu = wave_sum(s) * (1.0f / DM); float q = 0.f;
#pragma unroll
        for (int j = 0; j < 4; ++j) { z[j] = z[j] - mu; q += (z[j].x * z[j].x + z[j].y * z[j].y) + (z[j].z * z[j].z + z[j].w * z[j].w); }
        const float rstd = __builtin_amdgcn_rsqf(wave_sum(q) * (1.0f / DM) + LN_EPS);
#pragma unroll
        for (int j = 0; j < 4; ++j) { const int c = 256 * j + 4 * F.lane; const f32x4 o = z[j] * rstd * *(const GAS f32x4*)(lg + c) + *(const GAS f32x4*)(lb + c);
            *(GAS f32x4*)(out + (size_t)row * DM + c) = o;
            if (h2) { const f32x4 hh = o * (*(const GAS f32x4*)(mb + scoff + c) + 1.0f) + *(const GAS f32x4*)(mb + shoff + c);
                *(GAS unsigned long long*)(h2 + (size_t)row * DM + c) = (unsigned long long)pk2(hh.x, hh.y) | ((unsigned long long)pk2(hh.z, hh.w) << 32); } }
    }
}

struct Args { const float* in[21]; float* out; unsigned char* ws; int ph_lo, ph_hi, li, pad; };
__global__ void __launch_bounds__(NWAVES * 64, 2) skel_fwd(Args args) {
    extern __shared__ __attribute__((aligned(16))) unsigned char lds[];
    Frame F;
    F.lds = (LAS unsigned char*)lds; F.MISC = (volatile LAS unsigned*)(F.lds + MISC_OFF);
    F.tid = threadIdx.x; F.lane = F.tid & 63; F.wave = __builtin_amdgcn_readfirstlane(F.tid >> 6);
    F.G = gridDim.x; { const int bx = blockIdx.x; F.vcu = (F.G % 8 == 0) ? (bx % 8) * (F.G / 8) + bx / 8 : bx; }
    unsigned char* ws = args.ws; F.ctl = (gu32*)(ws + WS_CTL);
    In I; { const float* const* a = args.in; I.x = a[0]; I.c = a[1]; I.rel_bias = a[2]; I.w_ada = a[3]; I.b_ada = a[4]; I.w_in = a[5]; I.b_in = a[6]; I.sinks = a[7]; I.gln_g = a[8]; I.gln_b = a[9]; I.w_s = a[10]; I.b_s = a[11];
        I.ao_g = a[12]; I.go_g = a[13]; I.w_out = a[14]; I.ln1_g = a[15]; I.ln1_b = a[16]; I.w_gu = a[17]; I.w_d = a[18]; I.ln2_g = a[19]; I.ln2_b = a[20]; }
    for (int u = F.tid; u < (LDS_BYTES - LDSCTL_OFF) / 4; u += NWAVES * 64) ((LAS unsigned*)(F.lds + LDSCTL_OFF))[u] = 0u;
    __syncthreads();
    XcdBarrier bar; bar.bar = (unsigned*)(F.ctl + CW_BAR); bar.x = 0; bar.st = nullptr;
    if (!MK_PER_PHASE) bar = xcd_barrier_post((unsigned*)(F.ctl + CW_BAR), F.MISC + 8);
#define GRID_BAR() do { if (MK_PER_PHASE) { if (F.tid == 0) __hip_atomic_store(F.ctl + CW_TMO, 0xBADBA0u, RLX_AGENT); } else { xcd_barrier(bar); } } while (0)
    const int lo = args.ph_lo, hi = args.ph_hi;
#ifndef PH_MASK
#define PH_MASK 0x1ff
#endif
#define IN(k) (((PH_MASK >> (k)) & 1) && lo <= (k) && (k) < hi)
#define BOTH(k) (IN(k) && IN((k) + 1))
    bf16* Win = (bf16*)(ws + WS_WIN); bf16* Wout = (bf16*)(ws + WS_WOUT); bf16* Wgu = (bf16*)(ws + WS_WGU); bf16* Wd = (bf16*)(ws + WS_WD);
    bf16* PROJ = (bf16*)(ws + WS_PROJ); bf16* MIXED = (bf16*)(ws + WS_MIXED); bf16* HB = (bf16*)(ws + WS_H); bf16* HID = (bf16*)(ws + WS_HID);
    float* mod = (float*)(ws + WS_MOD);

    if (IN(0)) { p0_prologue(F, I, ws); if (BOTH(0)) GRID_BAR(); }
    if (IN(1)) { p1_hpass(F, I, ws); if (BOTH(1)) GRID_BAR(); }
    if (IN(2)) {
        pg8::Gemm g{HB, Win, MROWS, NIN, DM}; pg8::StaticOrder S; S.init(MROWS, NIN, F.G, (int)blockIdx.x);
        pg8::EpiProj E{PROJ, I.b_in, I.gln_g, I.gln_b};
        pg8::gemm_phase<pg8::EpiProj, pg8::StaticOrder, true, true>(F.lds + RING_OFF, g, S, E);
        if (BOTH(2)) GRID_BAR();
    }
    if (IN(3)) {
        tmx::Params tp{PROJ, MIXED, (const bf16*)(ws + WS_WS), I.rel_bias, I.sinks, I.b_s, I.ao_g, I.go_g};
        tmx::phase((TM_LAS char*)F.lds, tp, F.vcu, F.G);
        if (BOTH(3)) GRID_BAR();
    }
    if (IN(4)) {
        pg8::Gemm g{MIXED, Wout, MROWS, DM, DM}; pg8::StaticOrder S; S.init(MROWS, DM, F.G, (int)blockIdx.x);
        pg8::EpiF32 E{(float*)(ws + WS_Y1), DM};
        pg8::gemm_phase<pg8::EpiF32, pg8::StaticOrder, true, true>(F.lds + RING_OFF, g, S, E);
        if (BOTH(4)) GRID_BAR();
    }
    if (IN(5)) {
        ln_pass(F, I.x, (const float*)(ws + WS_Y1), mod, 2048, I.ln1_g, I.ln1_b, args.out, HB, 4096, 3072);
        if (BOTH(5)) GRID_BAR();
    }
    if (IN(6)) {
        pg8::Gemm g{HB, Wgu, MROWS, 2 * DFF, DM}; pg8::StaticOrder S; S.init(MROWS, 2 * DFF, F.G, (int)blockIdx.x);
        pg8::EpiSwiGLU E{HID};
        pg8::gemm_phase<pg8::EpiSwiGLU, pg8::StaticOrder, true, true>(F.lds + RING_OFF, g, S, E);
        if (BOTH(6)) GRID_BAR();
    }
    if (IN(7)) {
        pg8::Gemm g{HID, Wd, MROWS, DM, DFF}; pg8::StaticOrder S; S.init(MROWS, DM, F.G, (int)blockIdx.x);
        pg8::EpiF32 E{(float*)(ws + WS_Y2), DM};
        pg8::gemm_phase<pg8::EpiF32, pg8::StaticOrder, true, true>(F.lds + RING_OFF, g, S, E);
        if (BOTH(7)) GRID_BAR();
    }
    if (IN(8)) {
        ln_pass(F, args.out, (const float*)(ws + WS_Y2), mod, 5120, I.ln2_g, I.ln2_b, args.out, nullptr, 0, 0);
    }
#undef IN
#undef BOTH
}

static int fused_grid() {
    static int grid = 0;
    if (grid == 0) {
        int dev = 0, cus = 0, per_cu = 0;
        if (hipGetDevice(&dev) != hipSuccess || hipDeviceGetAttribute(&cus, hipDeviceAttributeMultiprocessorCount, dev) != hipSuccess) { fprintf(stderr, "kernel_launch: device query failed\n"); grid = -1; return grid; }
        if (hipFuncSetAttribute((const void*)skel_fwd, hipFuncAttributeMaxDynamicSharedMemorySize, LDS_BYTES) != hipSuccess) { fprintf(stderr, "kernel_launch: hipFuncSetAttribute failed\n"); grid = -1; return grid; }
        if (hipOccupancyMaxActiveBlocksPerMultiprocessor(&per_cu, (const void*)skel_fwd, NWAVES * 64, LDS_BYTES) != hipSuccess || per_cu < 1) fprintf(stderr, "kernel_launch: note: occupancy query reports %d workgroups per CU\n", per_cu);
        (void)hipGetLastError();
        grid = cus;
        if (grid != 256) fprintf(stderr, "kernel_launch: %d CUs; this kernel is built for 256\n", grid);
    }
    return grid;
}
static void fused_forward(void* const* d_in, float* out, unsigned char* ws, hipStream_t st, int lo, int hi) {
    const int grid = fused_grid(); if (grid < 0) return;
    Args a{}; for (int i = 0; i < 21; ++i) a.in[i] = (const float*)d_in[i];
    a.out = out; a.ws = ws;
    if (MK_PER_PHASE) { for (int p = lo; p < hi; ++p) { a.ph_lo = p; a.ph_hi = p + 1; a.li = 0; hipLaunchKernelGGL(skel_fwd, dim3(grid), dim3(NWAVES * 64), LDS_BYTES, st, a); } }
    else { a.ph_lo = lo; a.ph_hi = hi; a.li = 0; hipLaunchKernelGGL(skel_fwd, dim3(grid), dim3(NWAVES * 64), LDS_BYTES, st, a); }
    const hipError_t le = hipPeekAtLastError(); if (le != hipSuccess) fprintf(stderr, "kernel_launch: launch failed: %s\n", hipGetErrorName(le));
}

#ifndef HYB_MASK
#define HYB_MASK 0x3e
#endif
extern "C" void kernel_launch(void* const* d_in, const int* in_sizes, int n_in, void* d_out, int out_size, void* d_ws, size_t ws_size, hipStream_t stream) {
    if (n_in != 21 || out_size != MROWS * DM || ws_size < WS_END) { fprintf(stderr, "kernel_launch: unexpected shapes n_in %d out %d ws %zu\n", n_in, out_size, ws_size); return; }
    if (hipMemsetAsync((char*)d_ws + WS_CTL, 0, CTL_ZERO_BYTES, stream) != hipSuccess) { fprintf(stderr, "kernel_launch: memset failed\n"); return; }
    unsigned char* ws = (unsigned char*)d_ws; float* out = (float*)d_out;
#if MK_PER_PHASE
    fused_forward(d_in, out, ws, stream, 0, 2);
    if (HYB_MASK & 2) fused_forward(d_in, out, ws, stream, 2, 3); else naive_forward(d_in, out, ws, stream, 1, 2);
    if (HYB_MASK & 4) fused_forward(d_in, out, ws, stream, 3, 4); else naive_forward(d_in, out, ws, stream, 2, 3);
    if (HYB_MASK & 8) fused_forward(d_in, out, ws, stream, 4, 6); else naive_forward(d_in, out, ws, stream, 3, 4);
    if (HYB_MASK & 16) fused_forward(d_in, out, ws, stream, 6, 7); else naive_forward(d_in, out, ws, stream, 4, 5);
    if (HYB_MASK & 32) fused_forward(d_in, out, ws, stream, 7, 9); else naive_forward(d_in, out, ws, stream, 5, 6);
#else
    fused_forward(d_in, out, ws, stream, 0, N_PHASES);
#endif
}
```
